# Optimizing an MI355X kernel written in HIP

```python
import jax, jax.numpy as jnp
from jax import lax
import numpy as np

D_MODEL = 1024
BATCH = 16
SEQ = 2048
DEPTH = 4

HEAD_DIM = 64
N_HEADS = D_MODEL // 256
BRANCH_WIDTH = N_HEADS * HEAD_DIM
N_BRANCHES = 4
ROT_DIM = HEAD_DIM // 4
ROPE_THETA = 500000.0
Q_BLOCK = 128
DILATED_PAIRS = ((128, 1), (512, 4), (2048, 16))
WIN_BLOCK = 128
MOBA_BLOCK = 256
MOBA_TOPK = 3
MOBA_Q_CHUNK = 32
MLA_Q_RANK = D_MODEL // 4
MLA_KV_RANK = D_MODEL // 8
MLA_NOPE_DIM = 64
MLA_ROPE_DIM = 32
MLA_V_DIM = 64
D_FF = 4 * D_MODEL
NORM_EPS = 1e-6
FORGET_BIAS_INIT = 3.0
IN_SIZES = (3 * BRANCH_WIDTH, N_HEADS, 3 * BRANCH_WIDTH, 3 * BRANCH_WIDTH,
            MLA_Q_RANK, MLA_KV_RANK, MLA_ROPE_DIM, N_BRANCHES * D_MODEL)
D_IN = sum(IN_SIZES)

kernel_name = "hybrid_fox_dilated_moba_mla_block"


def rms_norm(x, g):
    xf = x.astype(jnp.float32)
    y = xf * lax.rsqrt(jnp.mean(jnp.square(xf), axis=-1, keepdims=True) + NORM_EPS)
    return (y * g.astype(jnp.float32)).astype(x.dtype)


def rope_tables(seq, dim):
    inv_freq = 1.0 / (ROPE_THETA ** (jnp.arange(0, dim, 2, dtype=jnp.float32) / dim))
    ang = jnp.arange(seq, dtype=jnp.float32)[:, None] * inv_freq[None, :]
    return jnp.cos(ang), jnp.sin(ang)


def apply_rope(x, cos, sin):
    xf = x.astype(jnp.float32)
    x1, x2 = jnp.split(xf, 2, axis=-1)
    return jnp.concatenate([x1 * cos - x2 * sin, x2 * cos + x1 * sin], axis=-1).astype(x.dtype)


def partial_rope(x, cos, sin):
    return jnp.concatenate([apply_rope(x[..., :ROT_DIM], cos, sin), x[..., ROT_DIM:]], axis=-1)


def to_heads(t):
    b, s, c = t.shape
    return t.reshape(b, s, N_HEADS, c // N_HEADS).transpose(0, 2, 1, 3)


def from_heads(t):
    b, h, s, d = t.shape
    return t.transpose(0, 2, 1, 3).reshape(b, s, h * d)


def blocked_causal_attention(q, k, v, scale, cum=None):
    b, h, s, dk = q.shape
    nq = s // Q_BLOCK
    qb = q.reshape(b, h, nq, Q_BLOCK, dk).transpose(2, 0, 1, 3, 4)
    kpos = jnp.arange(s)
    xs = (jnp.arange(nq), qb)
    if cum is not None:
        xs = xs + (cum.reshape(b, h, nq, Q_BLOCK).transpose(2, 0, 1, 3),)

    def one_block(args):
        qpos = args[0] * Q_BLOCK + jnp.arange(Q_BLOCK)
        sc = jnp.einsum('bhqd,bhkd->bhqk', args[1], k).astype(jnp.float32) * scale
        if cum is not None:
            sc = sc + args[2][..., :, None] - cum[:, :, None, :]
        sc = jnp.where(kpos[None, :] <= qpos[:, None], sc, -jnp.inf)
        p = jax.nn.softmax(sc, axis=-1).astype(v.dtype)
        return jnp.einsum('bhqk,bhkd->bhqd', p, v)

    out = lax.map(one_block, xs)
    return out.transpose(1, 2, 0, 3, 4).reshape(b, h, s, v.shape[-1])


def banded_window_attention(q, k, v, window, scale):
    n, length, dh = q.shape
    lp = -(-length // WIN_BLOCK) * WIN_BLOCK
    pad = ((0, 0), (0, lp - length), (0, 0))
    nb = lp // WIN_BLOCK
    qb, kb, vb = (jnp.pad(t, pad).reshape(n, nb, WIN_BLOCK, dh) for t in (q, k, v))

    def with_prev(t):
        prev = jnp.pad(t, ((0, 0), (1, 0), (0, 0), (0, 0)))[:, :-1]
        return jnp.concatenate([prev, t], axis=2)

    k2, v2 = with_prev(kb), with_prev(vb)
    sc = jnp.einsum('nbqd,nbkd->nbqk', qb, k2).astype(jnp.float32) * scale
    qi = jnp.arange(WIN_BLOCK)[:, None] + WIN_BLOCK
    kj = jnp.arange(2 * WIN_BLOCK)[None, :]
    dist = qi - kj
    band = (dist >= 0) & (dist <= window)
    real = (jnp.arange(nb) > 0)[:, None, None] | (kj >= WIN_BLOCK)[None]
    sc = jnp.where(band[None] & real, sc, -jnp.inf)
    lse = jax.nn.logsumexp(sc, axis=-1)
    p = jnp.exp(sc - lse[..., None]).astype(v.dtype)
    out = jnp.einsum('nbqk,nbkd->nbqd', p, v2).reshape(n, lp, dh)[:, :length]
    return out, lse.reshape(n, lp)[:, :length]


def dilated_attention(q, k, v):
    b, h, s, dh = q.shape
    scale = dh ** -0.5
    outs, lses = [], []
    for window, dil in DILATED_PAIRS:
        sub = s // dil

        def to_sub(t):
            return t.reshape(b, h, sub, dil, dh).transpose(0, 1, 3, 2, 4).reshape(b * h * dil, sub, dh)

        o, l = banded_window_attention(to_sub(q), to_sub(k), to_sub(v), window // dil, scale)
        outs.append(o.reshape(b, h, dil, sub, dh).transpose(0, 1, 3, 2, 4).reshape(b, h, s, dh))
        lses.append(l.reshape(b, h, dil, sub).transpose(0, 1, 3, 2).reshape(b, h, s))
    wts = jax.nn.softmax(jnp.stack(lses, axis=0), axis=0)
    return jnp.sum(wts[..., None].astype(v.dtype) * jnp.stack(outs, axis=0), axis=0)


def moba_attention(q, k, v):
    b, h, s, dh = q.shape
    scale = dh ** -0.5
    sp = -(-s // MOBA_BLOCK) * MOBA_BLOCK
    padw = ((0, 0), (0, 0), (0, sp - s), (0, 0))
    q, k, v = jnp.pad(q, padw), jnp.pad(k, padw), jnp.pad(v, padw)
    nblk = sp // MOBA_BLOCK
    n_sel = min(MOBA_TOPK, nblk - 1)
    kb = k.reshape(b, h, nblk, MOBA_BLOCK, dh)
    vb = v.reshape(b, h, nblk, MOBA_BLOCK, dh)
    nc = sp // MOBA_Q_CHUNK
    xs = (jnp.arange(nc), q.reshape(b, h, nc, MOBA_Q_CHUNK, dh).transpose(2, 0, 1, 3, 4))
    if n_sel > 0:
        kmean = jnp.mean(kb.astype(jnp.float32), axis=3)
        gate = jnp.einsum('bhsd,bhnd->bhsn', q.astype(jnp.float32), kmean)
        past = jnp.arange(nblk)[None, :] < (jnp.arange(sp) // MOBA_BLOCK)[:, None]
        _, sel = lax.top_k(jnp.where(past, gate, -jnp.inf), n_sel)
        xs = xs + (sel.reshape(b, h, nc, MOBA_Q_CHUNK, n_sel).transpose(2, 0, 1, 3, 4),)
    bi = jnp.arange(b)[:, None, None, None]
    hi = jnp.arange(h)[None, :, None, None]

    def one_chunk(args):
        i, qi = args[0], args[1]
        qpos = i * MOBA_Q_CHUNK + jnp.arange(MOBA_Q_CHUNK)
        own = (i * MOBA_Q_CHUNK) // MOBA_BLOCK
        k_own = lax.dynamic_index_in_dim(kb, own, axis=2, keepdims=False)
        v_own = lax.dynamic_index_in_dim(vb, own, axis=2, keepdims=False)
        kpos = own * MOBA_BLOCK + jnp.arange(MOBA_BLOCK)
        s_own = jnp.einsum('bhqd,bhkd->bhqk', qi, k_own).astype(jnp.float32) * scale
        s_own = jnp.where(kpos[None, :] <= qpos[:, None], s_own, -jnp.inf)
        if n_sel == 0:
            p = jax.nn.softmax(s_own, axis=-1).astype(v.dtype)
            return jnp.einsum('bhqk,bhkd->bhqd', p, v_own)
        seli = args[2]
        k_sel = kb[bi, hi, seli]
        v_sel = vb[bi, hi, seli]
        s_sel = jnp.einsum('bhqd,bhqnkd->bhqnk', qi, k_sel).astype(jnp.float32) * scale
        valid = jnp.arange(n_sel)[None, :] < (qpos // MOBA_BLOCK)[:, None]
        s_sel = jnp.where(valid[:, :, None], s_sel, -jnp.inf)
        s_sel = s_sel.reshape(b, h, MOBA_Q_CHUNK, n_sel * MOBA_BLOCK)
        p = jax.nn.softmax(jnp.concatenate([s_sel, s_own], axis=-1), axis=-1)
        p_sel = p[..., :n_sel * MOBA_BLOCK].reshape(b, h, MOBA_Q_CHUNK, n_sel, MOBA_BLOCK).astype(v.dtype)
        p_own = p[..., n_sel * MOBA_BLOCK:].astype(v.dtype)
        return (jnp.einsum('bhqnk,bhqnkd->bhqd', p_sel, v_sel)
                + jnp.einsum('bhqk,bhkd->bhqd', p_own, v_own))

    out = lax.map(one_chunk, xs)
    return out.transpose(1, 2, 0, 3, 4).reshape(b, h, sp, dh)[:, :, :s]


def mla_attention(cq_raw, ckv_raw, kr_raw, g_cq, g_ckv, w_uq, w_uk, w_uv, cos_m, sin_m):
    b, s, _ = cq_raw.shape
    c_q = rms_norm(cq_raw, g_cq)
    c_kv = rms_norm(ckv_raw, g_ckv)
    q = to_heads(c_q @ w_uq)
    q = jnp.concatenate([q[..., :MLA_NOPE_DIM], apply_rope(q[..., MLA_NOPE_DIM:], cos_m, sin_m)], axis=-1)
    k_nope = to_heads(c_kv @ w_uk)
    v = to_heads(c_kv @ w_uv)
    k_rope = apply_rope(kr_raw[:, None], cos_m, sin_m)
    k = jnp.concatenate([k_nope, jnp.broadcast_to(k_rope, (b, N_HEADS, s, MLA_ROPE_DIM))], axis=-1)
    return blocked_causal_attention(q, k, v, (MLA_NOPE_DIM + MLA_ROPE_DIM) ** -0.5)


def hybrid_mixer(h, w_in, b_forget, g_cq, g_ckv, w_uq, w_uk, w_uv, w_branch, w_out,
                 cos_p, sin_p, cos_m, sin_m):
    b, s, d = h.shape
    proj = h @ w_in
    offs = np.cumsum(IN_SIZES)[:-1].tolist()
    fox_qkv, fox_f, dil_qkv, moba_qkv, mla_cq, mla_ckv, mla_kr, gates = jnp.split(proj, offs, axis=-1)

    q, k, v = (to_heads(t) for t in jnp.split(fox_qkv, 3, axis=-1))
    log_f = jax.nn.log_sigmoid((fox_f + b_forget).astype(jnp.float32))
    cum = jnp.cumsum(log_f, axis=1).transpose(0, 2, 1)
    y_fox = blocked_causal_attention(q, k, v, HEAD_DIM ** -0.5, cum)

    q, k, v = (to_heads(t) for t in jnp.split(dil_qkv, 3, axis=-1))
    y_dil = dilated_attention(partial_rope(q, cos_p, sin_p), partial_rope(k, cos_p, sin_p), v)

    q, k, v = (to_heads(t) for t in jnp.split(moba_qkv, 3, axis=-1))
    y_moba = moba_attention(partial_rope(q, cos_p, sin_p), partial_rope(k, cos_p, sin_p), v)

    y_mla = mla_attention(mla_cq, mla_ckv, mla_kr, g_cq, g_ckv, w_uq, w_uk, w_uv, cos_m, sin_m)

    ys = jnp.stack([from_heads(y_fox), from_heads(y_dil), from_heads(y_moba), from_heads(y_mla)], axis=2)
    u = jnp.einsum('bsnc,ncd->bsnd', ys, w_branch)
    g = jax.nn.sigmoid(gates.reshape(b, s, N_BRANCHES, d))
    merged = jnp.sum(g * u, axis=2)
    return merged @ w_out


def squared_relu_mlp(h, w_up, w_down):
    return jnp.square(jax.nn.relu(h @ w_up)) @ w_down


def setup_inputs(seed: int = 0) -> dict:
    key = jax.random.key(seed)
    ks = jax.random.split(key, 16)

    def nrm(k, shape, fan_in):
        return jax.random.normal(k, shape, jnp.float32) * fan_in ** -0.5

    def gain(k, shape):
        return 1.0 + 0.05 * jax.random.normal(k, shape, jnp.float32)

    return {
        "x": jax.random.normal(ks[0], (BATCH, SEQ, D_MODEL), jnp.float32),
        "w_in": nrm(ks[1], (DEPTH, D_MODEL, D_IN), D_MODEL),
        "b_forget": FORGET_BIAS_INIT + 0.5 * jax.random.normal(ks[2], (DEPTH, N_HEADS), jnp.float32),
        "g_cq": gain(ks[3], (DEPTH, MLA_Q_RANK)),
        "g_ckv": gain(ks[4], (DEPTH, MLA_KV_RANK)),
        "w_uq": nrm(ks[5], (DEPTH, MLA_Q_RANK, N_HEADS * (MLA_NOPE_DIM + MLA_ROPE_DIM)), MLA_Q_RANK),
        "w_uk": nrm(ks[6], (DEPTH, MLA_KV_RANK, N_HEADS * MLA_NOPE_DIM), MLA_KV_RANK),
        "w_uv": nrm(ks[7], (DEPTH, MLA_KV_RANK, N_HEADS * MLA_V_DIM), MLA_KV_RANK),
        "w_branch": nrm(ks[8], (DEPTH, N_BRANCHES, BRANCH_WIDTH, D_MODEL), BRANCH_WIDTH),
        "w_out": nrm(ks[9], (DEPTH, D_MODEL, D_MODEL), D_MODEL),
        "w_up": nrm(ks[10], (DEPTH, D_MODEL, D_FF), D_MODEL),
        "w_down": nrm(ks[11], (DEPTH, D_FF, D_MODEL), D_FF),
        "g_pre_mix": gain(ks[12], (DEPTH, D_MODEL)),
        "g_post_mix": gain(ks[13], (DEPTH, D_MODEL)),
        "g_pre_mlp": gain(ks[14], (DEPTH, D_MODEL)),
        "g_post_mlp": gain(ks[15], (DEPTH, D_MODEL)),
    }


def reference(x, w_in, b_forget, g_cq, g_ckv, w_uq, w_uk, w_uv, w_branch, w_out, w_up, w_down,
              g_pre_mix, g_post_mix, g_pre_mlp, g_post_mlp):
    s = x.shape[1]
    cos_p, sin_p = rope_tables(s, ROT_DIM)
    cos_m, sin_m = rope_tables(s, MLA_ROPE_DIM)
    for l in range(DEPTH):
        h = rms_norm(x, g_pre_mix[l])
        mix = hybrid_mixer(h, w_in[l], b_forget[l], g_cq[l], g_ckv[l], w_uq[l], w_uk[l], w_uv[l],
                           w_branch[l], w_out[l], cos_p, sin_p, cos_m, sin_m)
        x = x + rms_norm(mix, g_post_mix[l])
        h = rms_norm(x, g_pre_mlp[l])
        x = x + rms_norm(squared_relu_mlp(h, w_up[l], w_down[l]), g_post_mlp[l])
    return x
```

```cpp
#include <hip/hip_runtime.h>
#include <cstdio>
#include <cstdint>
#ifndef PHM
#define PHM 0xfffff
#endif

#define GAS __attribute__((address_space(1)))
#define LAS __attribute__((address_space(3)))
typedef unsigned short bf16;
typedef short bf16x8 __attribute__((ext_vector_type(8)));
typedef short s16x4 __attribute__((ext_vector_type(4)));
typedef float f32x2 __attribute__((ext_vector_type(2)));
typedef float f32x4 __attribute__((ext_vector_type(4)));
typedef float f32x16 __attribute__((ext_vector_type(16)));
typedef unsigned u32x2 __attribute__((ext_vector_type(2)));
typedef unsigned u32x4 __attribute__((ext_vector_type(4)));

constexpr int D = 1024, BATCH = 16, SEQ = 2048, DEPTH = 4, M = BATCH * SEQ, NH = 4, HD = 64, DFF = 4096;
constexpr int DIN = 6820;
constexpr int PW = 2816;
constexpr int C_FQ = 0, C_FK = 256, C_FV = 512, C_DQ = 768, C_DK = 1024, C_DV = 1280, C_MQ = 1536, C_MK = 1792, C_MV = 2048,
              C_CQ = 2304, C_CKV = 2560, C_KR = 2688, C_FF = 2720;
constexpr float LOG2E = 1.4426950408889634f;
constexpr float QS = 0.125f * LOG2E;
constexpr float MS = 0.10206207261596577f * LOG2E;
constexpr float NORM_EPS = 1e-6f;

constexpr size_t MiB = 1u << 20;
constexpr size_t WS_CTL = 0, CTL_ZERO_BYTES = 1 * MiB;
constexpr size_t WS_CUM = 1 * MiB;
constexpr size_t WS_KSUM = WS_CUM + 512 * 1024;
constexpr size_t WS_RSQ = WS_KSUM + 256 * 1024;
constexpr size_t WS_RSKV = WS_RSQ + 128 * 1024;
constexpr size_t WS_ROPE = 2 * MiB;
constexpr size_t WS_LSE = 3 * MiB;
constexpr size_t WS_W = 8 * MiB;
constexpr size_t W_IN = 0, W_G = W_IN + (size_t)PW * 1024 * 2, W_UQ = W_G + (size_t)4096 * 1024 * 2, W_UKV = W_UQ + 512 * 256 * 2,
                 W_B = W_UKV + 512 * 256 * 2, W_O = W_B + 1024 * 1024 * 2, W_UP = W_O + 1024 * 1024 * 2, W_DN = W_UP + (size_t)4096 * 1024 * 2,
                 W_END = W_DN + (size_t)4096 * 1024 * 2;
static_assert(W_END == 34 * MiB, "weights");
constexpr size_t WS_H = 42 * MiB;
constexpr size_t WS_PROJ = 106 * MiB;
constexpr size_t WS_HID = WS_PROJ;
constexpr size_t WS_MERGED = WS_PROJ;
constexpr size_t WS_USCR = WS_PROJ + 64 * MiB;
constexpr size_t WS_YS = 282 * MiB;
constexpr size_t WS_QM = 346 * MiB;
constexpr size_t WS_KNVM = 370 * MiB;
constexpr size_t WS_OD = 402 * MiB;
constexpr size_t WS_END = 434 * MiB;
constexpr int CW_BAR = 4096;

constexpr int RING_BYTES = 131072;
constexpr int MISC_OFF = RING_BYTES;
constexpr int LDS_BYTES = 147456;

__device__ __forceinline__ unsigned f2bf(float f) { unsigned u = __builtin_bit_cast(unsigned, f); return (u + 0x7fffu + ((u >> 16) & 1u)) >> 16; }
__device__ __forceinline__ unsigned pk2(float lo, float hi) { return f2bf(lo) | (f2bf(hi) << 16); }
__device__ __forceinline__ float bf2f(unsigned h) { return __builtin_bit_cast(float, h << 16); }
__device__ __forceinline__ float bflo(unsigned w) { return __builtin_bit_cast(float, w << 16); }
__device__ __forceinline__ float bfhi(unsigned w) { return __builtin_bit_cast(float, w & 0xffff0000u); }
__device__ __forceinline__ unsigned cvt_pk_bf16(float lo, float hi) { unsigned r; asm volatile("v_cvt_pk_bf16_f32 %0, %1, %2" : "=v"(r) : "v"(lo), "v"(hi)); return r; }
__device__ __forceinline__ float wave_sum(float v) {
#pragma unroll
    for (int o = 1; o < 64; o <<= 1) v += __shfl_xor(v, o);
    return v;
}

__device__ __forceinline__ int my_tid() { int t = threadIdx.x; asm volatile("" : "+v"(t)); return t; }
__device__ __forceinline__ int my_bid() { int t = blockIdx.x; asm volatile("" : "+s"(t)); return t; }
__device__ __forceinline__ int my_grid() { int t = gridDim.x; asm volatile("" : "+s"(t)); return t; }

namespace pg8 {
constexpr int BM = 256, BK = 64, HALF = 128, HTB = HALF * BK * 2, STAGE_BYTES = 8 * HTB, NXCD = 8, WGM = 8;
__host__ __device__ __forceinline__ int lds_byte(int r, int c) { const int st = (r >> 4) * 2 + (c >> 5), rr = r & 15, cc = c & 31, ob = rr * 64 + cc * 2; return st * 1024 + (ob ^ (((ob >> 9) & 1) << 5)); }
__host__ __device__ __forceinline__ void stage_rc(int b, int& R, int& C) { const int st = b / 1024, sb = b % 1024, swz = sb ^ (((sb >> 9) & 1) << 5); R = (st >> 1) * 16 + swz / 64; C = (st & 1) * 32 + (swz % 64) / 2; }
__host__ __device__ __forceinline__ int perm32(int rho) { const int n = rho >> 4, i = rho & 15; return 8 * (i >> 2) + 4 * n + (i & 3); }

struct Unit { const char* A; const char* B; int nt; int pm, pn, tag; };

__device__ __forceinline__ void tile_of(int L, int nM, int nN, int& pm, int& pn) {
    const int nwg = nM * nN; int wgid = L;
    { const int q = nwg / NXCD, r = nwg % NXCD, xcd = wgid % NXCD, off = wgid / NXCD; wgid = (xcd < r ? xcd * (q + 1) : r * (q + 1) + (xcd - r) * q) + off; }
    const int nig = WGM * nN, gid = wgid / nig, fm = gid * WGM, gsz = (nM - fm) < WGM ? (nM - fm) : WGM;
    pm = fm + ((wgid % nig) % gsz); pn = (wgid % nig) / gsz;
}

template <class Epi, class Sched>
__device__ __forceinline__ void gemm_phase(LAS unsigned char* lds, const unsigned pa, const unsigned pb, const Sched& S, const Epi& E) {
    const int tid = my_tid(), wid = __builtin_amdgcn_readfirstlane(tid >> 6), lane = tid & 63, wr = wid >> 2, wc = wid & 3, fr = lane & 15, fq = lane >> 4;
    unsigned voffA[2], voffB[2];
#pragma unroll
    for (int i = 0; i < 2; ++i) { int R, C; stage_rc(tid * 16 + i * 8192, R, C); const int Rb = (R & ~31) + perm32(R & 31);
        voffA[i] = (unsigned)R * pa + (unsigned)C * 2u; voffB[i] = (unsigned)Rb * pb + (unsigned)C * 2u; }
    const size_t kstep = (size_t)(BK * 2);
    const size_t hstepA = (size_t)HALF * pa, hstepB = (size_t)HALF * pb;
    const unsigned ldsw = (unsigned)wid * 1024u;
    const int aoff = lds_byte(wr * 64 + fr, fq * 8), boff = lds_byte(wc * 32 + fr, fq * 8);
#define PG8_SA(b, h) (((b) * 2 + (h)) * HTB)
#define PG8_SB(b, h) ((4 + (b) * 2 + (h)) * HTB)
#define PG8_STAGE(bufoff, gbase, voff) do { _Pragma("unroll") for (int _i = 0; _i < 2; ++_i) \
        __builtin_amdgcn_global_load_lds((const unsigned*)((const char*)(gbase) + (voff)[_i]), (LAS unsigned*)(lds + (bufoff) + ldsw + _i * 8192), 16, 0, 0); } while (0)
#define PG8_LDA(dst, b, h) do { _Pragma("unroll") for (int m = 0; m < 4; ++m) _Pragma("unroll") for (int k = 0; k < 2; ++k) dst[m][k] = *(const LAS bf16x8*)(lds + PG8_SA(b, h) + aoff + m * 2048 + k * 1024); } while (0)
#define PG8_LDB(dst, b, h) do { _Pragma("unroll") for (int n = 0; n < 2; ++n) _Pragma("unroll") for (int k = 0; k < 2; ++k) dst[n][k] = *(const LAS bf16x8*)(lds + PG8_SB(b, h) + boff + n * 2048 + k * 1024); } while (0)
#define PG8_MMA(ai, bj, At, Bt) do { __builtin_amdgcn_s_setprio(1); _Pragma("unroll") for (int m = 0; m < 4; ++m) _Pragma("unroll") for (int n = 0; n < 2; ++n) _Pragma("unroll") for (int k = 0; k < 2; ++k) \
        acc[ai][bj][m][n] = __builtin_amdgcn_mfma_f32_16x16x32_bf16(Bt[n][k], At[m][k], acc[ai][bj][m][n], 0, 0, 0); __builtin_amdgcn_s_setprio(0); } while (0)
#define PG8_WAIT_V(n) asm volatile("s_waitcnt vmcnt(" #n ")" ::: "memory")
#define PG8_WAIT_L(n) asm volatile("s_waitcnt lgkmcnt(" #n ")" ::: "memory")
#define PG8_BAR __builtin_amdgcn_s_barrier()
#define PG8_SCHED __builtin_amdgcn_sched_barrier(0)
    Unit cur, nxt; int ui = 0;
    if (!S.next(0, cur)) return;
    f32x4 acc[2][2][4][2];
#pragma unroll
    for (int a = 0; a < 2; ++a)
#pragma unroll
        for (int b = 0; b < 2; ++b)
#pragma unroll
            for (int m = 0; m < 4; ++m)
#pragma unroll
                for (int n = 0; n < 2; ++n) acc[a][b][m][n] = (f32x4){0.f, 0.f, 0.f, 0.f};
    bf16x8 At[4][2], B0[2][2], B1[2][2];
    const char* cA = cur.A; const char* cB = cur.B;
    PG8_STAGE(PG8_SB(0, 0), cB, voffB); PG8_STAGE(PG8_SB(0, 1), cB + hstepB, voffB); PG8_STAGE(PG8_SA(0, 0), cA, voffA); PG8_STAGE(PG8_SA(0, 1), cA + hstepA, voffA);
    if (wr == 1) PG8_BAR;
    PG8_WAIT_V(2); PG8_BAR;
    PG8_STAGE(PG8_SB(1, 0), cB + kstep, voffB); PG8_STAGE(PG8_SA(1, 0), cA + kstep, voffA); PG8_STAGE(PG8_SB(1, 1), cB + hstepB + kstep, voffB);
    PG8_WAIT_V(6); PG8_BAR;
    for (;;) {
        const bool has_next = S.next(ui + 1, nxt);
        const char* nA = has_next ? nxt.A : cA; const char* nB = has_next ? nxt.B : cB;
        const int nt = cur.nt;
        for (int t = 0; t < nt; t += 2) {
            const bool last = (t == nt - 2);
            const char* a1 = cA + (size_t)(t + 1) * kstep;
            const char* a2 = last ? nA : cA + (size_t)(t + 2) * kstep; const char* b2 = last ? nB : cB + (size_t)(t + 2) * kstep;
            const char* a3 = a2 + kstep; const char* b3 = b2 + kstep;
            PG8_LDB(B0, 0, 0); PG8_LDB(B1, 0, 1); PG8_SCHED; PG8_LDA(At, 0, 0); PG8_STAGE(PG8_SA(1, 1), a1 + hstepA, voffA);
            PG8_WAIT_V(8); PG8_WAIT_L(0); PG8_BAR; PG8_MMA(0, 0, At, B0); PG8_MMA(0, 1, At, B1); PG8_BAR; PG8_SCHED;
            PG8_LDA(At, 0, 1); PG8_STAGE(PG8_SB(0, 0), b2, voffB); PG8_STAGE(PG8_SB(0, 1), b2 + hstepB, voffB); PG8_STAGE(PG8_SA(0, 0), a2, voffA);
            PG8_WAIT_V(8); PG8_WAIT_L(0); PG8_BAR; PG8_MMA(1, 0, At, B0); PG8_MMA(1, 1, At, B1); PG8_BAR; PG8_SCHED;
            PG8_LDB(B0, 1, 0); PG8_LDB(B1, 1, 1); PG8_SCHED; PG8_LDA(At, 1, 0); PG8_STAGE(PG8_SA(0, 1), a2 + hstepA, voffA);
            PG8_WAIT_V(8); PG8_WAIT_L(0); PG8_BAR; PG8_MMA(0, 0, At, B0); PG8_MMA(0, 1, At, B1); PG8_BAR; PG8_SCHED;
            PG8_LDA(At, 1, 1); PG8_STAGE(PG8_SB(1, 0), b3, voffB); PG8_STAGE(PG8_SB(1, 1), b3 + hstepB, voffB); PG8_STAGE(PG8_SA(1, 0), a3, voffA);
            PG8_WAIT_V(8); PG8_WAIT_L(0); PG8_BAR; PG8_MMA(1, 0, At, B0); PG8_MMA(1, 1, At, B1); PG8_BAR; PG8_SCHED;
        }
        if (wr == 0) PG8_BAR;
        E(acc, cur, wr, wc, fr, fq);
        if (!has_next) break;
#pragma unroll
        for (int a = 0; a < 2; ++a)
#pragma unroll
            for (int b = 0; b < 2; ++b)
#pragma unroll
                for (int m = 0; m < 4; ++m)
#pragma unroll
                    for (int n = 0; n < 2; ++n) acc[a][b][m][n] = (f32x4){0.f, 0.f, 0.f, 0.f};
        cur = nxt; cA = nA; cB = nB; ++ui;
        if (wr == 1) PG8_BAR;
    }
    PG8_WAIT_V(0);
    PG8_BAR;
#undef PG8_SA
#undef PG8_SB
#undef PG8_STAGE
#undef PG8_LDA
#undef PG8_LDB
#undef PG8_MMA
#undef PG8_WAIT_V
#undef PG8_WAIT_L
#undef PG8_BAR
#undef PG8_SCHED
}

template <int MODE> struct EpiStore {
    bf16* O; int ldc; const float* rs; int ncol_valid; int row_off;
    __device__ __forceinline__ void operator()(const f32x4 (&acc)[2][2][4][2], const Unit& u, int, int, int, int) const {
        const int t_ = my_tid(), wid_ = __builtin_amdgcn_readfirstlane(t_ >> 6), wr = wid_ >> 2, wc = wid_ & 3, fr = t_ & 15, fq = (t_ & 63) >> 4;
        const int row0 = u.pm * BM + wr * 64 + fr; const int col0 = u.pn * BM + wc * 32 + 8 * fq;
#pragma unroll
        for (int ai = 0; ai < 2; ++ai)
#pragma unroll
            for (int m = 0; m < 4; ++m) { const int row = row0 + ai * HALF + m * 16; bf16* rowp = O + (size_t)(row + row_off) * ldc + col0;
                float sc = 1.f; if (MODE == 2) sc = rs[row];
#pragma unroll
                for (int bj = 0; bj < 2; ++bj) { f32x4 v0 = acc[ai][bj][m][0], v1 = acc[ai][bj][m][1];
                    if (MODE == 1) {
#pragma unroll
                        for (int e = 0; e < 4; ++e) { float a = v0[e] > 0.f ? v0[e] : 0.f; v0[e] = a * a; float b = v1[e] > 0.f ? v1[e] : 0.f; v1[e] = b * b; } }
                    if (MODE == 2) { v0 = v0 * sc; v1 = v1 * sc; }
                    u32x4 w; w.x = cvt_pk_bf16(v0[0], v0[1]); w.y = cvt_pk_bf16(v0[2], v0[3]); w.z = cvt_pk_bf16(v1[0], v1[1]); w.w = cvt_pk_bf16(v1[2], v1[3]);
                    if (col0 + bj * HALF < ncol_valid) *(u32x4*)(rowp + bj * HALF) = w; } }
    }
};
struct EpiGate {
    bf16* scr;
    bf16* Mg;
    __device__ __forceinline__ void operator()(const f32x4 (&acc)[2][2][4][2], const Unit& u, int, int, int, int) const {
        const int t_ = my_tid(), wid_ = __builtin_amdgcn_readfirstlane(t_ >> 6), wr = wid_ >> 2, wc = wid_ & 3, fr = t_ & 15, fq = (t_ & 63) >> 4;
        const int kind = u.tag & 1, nb = u.tag >> 1;
        const int lrow0 = wr * 64 + fr, lcol0 = wc * 32 + 8 * fq;
#pragma unroll
        for (int ai = 0; ai < 2; ++ai)
#pragma unroll
            for (int m = 0; m < 4; ++m) { const int lrow = lrow0 + ai * HALF + m * 16;
#pragma unroll
                for (int bj = 0; bj < 2; ++bj) { const f32x4 v0 = acc[ai][bj][m][0], v1 = acc[ai][bj][m][1];
                    bf16* sp = scr + lrow * 256 + lcol0 + bj * HALF;
                    if (kind == 0) {
                        u32x4 w; w.x = cvt_pk_bf16(v0[0], v0[1]); w.y = cvt_pk_bf16(v0[2], v0[3]); w.z = cvt_pk_bf16(v1[0], v1[1]); w.w = cvt_pk_bf16(v1[2], v1[3]);
                        *(u32x4*)sp = w;
                    } else {
                        const unsigned long long ua = __hip_atomic_load((unsigned long long*)sp, __ATOMIC_RELAXED, __HIP_MEMORY_SCOPE_AGENT);
                        const unsigned long long ub = __hip_atomic_load((unsigned long long*)sp + 1, __ATOMIC_RELAXED, __HIP_MEMORY_SCOPE_AGENT);
                        bf16* mp = Mg + (size_t)(u.pm * BM + lrow) * 1024 + u.pn * BM + lcol0 + bj * HALF;
                        unsigned long long ma = 0ull, mb = 0ull;
                        if (nb > 0) { ma = __hip_atomic_load((unsigned long long*)mp, __ATOMIC_RELAXED, __HIP_MEMORY_SCOPE_AGENT);
                                      mb = __hip_atomic_load((unsigned long long*)mp + 1, __ATOMIC_RELAXED, __HIP_MEMORY_SCOPE_AGENT); }
                        const unsigned uw[4] = {(unsigned)ua, (unsigned)(ua >> 32), (unsigned)ub, (unsigned)(ub >> 32)};
                        const unsigned mw[4] = {(unsigned)ma, (unsigned)(ma >> 32), (unsigned)mb, (unsigned)(mb >> 32)};
                        float g[8] = {v0[0], v0[1], v0[2], v0[3], v1[0], v1[1], v1[2], v1[3]};
                        unsigned ow[4];
#pragma unroll
                        for (int e = 0; e < 4; ++e) {
                            const float s0 = __builtin_amdgcn_rcpf(1.f + __builtin_amdgcn_exp2f(-g[2 * e])), s1 = __builtin_amdgcn_rcpf(1.f + __builtin_amdgcn_exp2f(-g[2 * e + 1]));
                            const float r0 = bflo(mw[e]) + s0 * bflo(uw[e]), r1 = bfhi(mw[e]) + s1 * bfhi(uw[e]);
                            ow[e] = cvt_pk_bf16(r0, r1); }
                        u32x4 w; w.x = ow[0]; w.y = ow[1]; w.z = ow[2]; w.w = ow[3];
                        *(u32x4*)mp = w;
                    } }
                __builtin_amdgcn_sched_barrier(0); }
    }
};
}

#define XB_TMO      128
#define XB_XCNT(j)  (256  + 64 * (j))
#define XB_XSUB(j)  (1280 + 64 * (j))
#define XB_XGEN(j)  (2304 + 64 * (j))
#define XB_TOP      3328
#define XB_TOPGEN   3392
#define XCD_BAR_WORDS 3456
#define XB_SPIN_CAP (1u << 18)

__device__ __forceinline__ unsigned xb_ld(unsigned* p)              { return __hip_atomic_load(p, __ATOMIC_RELAXED, __HIP_MEMORY_SCOPE_AGENT); }
__device__ __forceinline__ unsigned xb_add(unsigned* p, unsigned v) { return __hip_atomic_fetch_add(p, v, __ATOMIC_RELAXED, __HIP_MEMORY_SCOPE_AGENT); }
__device__ __forceinline__ unsigned xb_xcc_id() { return (unsigned)__builtin_amdgcn_s_getreg((3 << 11) | 20) & 0xFu; }
#define XB_SPIN(cond, bar) do { unsigned _sp = 0; while (cond) { __builtin_amdgcn_s_sleep(1); \
    if ((++_sp & 255u) == 0u) { if (xb_ld(&(bar)[XB_TMO])) break; if (_sp > XB_SPIN_CAP) { atomicAdd(&(bar)[XB_TMO], 1u); break; } } } } while (0)

struct XcdBarrier { unsigned* bar; unsigned x; volatile LAS unsigned* st; };

__device__ __forceinline__ XcdBarrier xcd_barrier_post(unsigned* bar, volatile LAS unsigned* st) {
    XcdBarrier b; b.bar = bar; b.x = xb_xcc_id(); b.st = st;
    if (threadIdx.x == 0) (void)xb_add(&bar[XB_XCNT(b.x)], 1u);
    return b;
}
__device__ __forceinline__ void xcd_barrier_complete(unsigned* bar, unsigned x, unsigned& nloc, unsigned& nx) {
    const unsigned G = gridDim.x * gridDim.y * gridDim.z;
    unsigned sum, cnt, mine, sp = 0u;
    for (;;) {
        sum = 0u; cnt = 0u; mine = 0u;
#pragma unroll
        for (unsigned j = 0; j < 16; ++j) { const unsigned c = xb_ld(&bar[XB_XCNT(j)]); sum += c; cnt += (c > 0u) ? 1u : 0u; mine = (j == x) ? c : mine; }
        if (sum == G) break;
        __builtin_amdgcn_s_sleep(1);
        if ((++sp & 255u) == 0u) { if (xb_ld(&bar[XB_TMO])) break; if (sp > XB_SPIN_CAP) { atomicAdd(&bar[XB_TMO], 1u); break; } }
    }
    nloc = mine > 0u ? mine : 1u; nx = cnt > 0u ? cnt : 1u;
}
__device__ __forceinline__ void xcd_barrier(const XcdBarrier& b) {
    asm volatile("s_waitcnt vmcnt(0)" ::: "memory");
    __syncthreads();
    if (threadIdx.x == 0) {
        unsigned* bar = b.bar;
        __builtin_amdgcn_s_waitcnt(0);
        unsigned nloc = b.st[0], nx = b.st[1];
        if (nloc == 0u) { xcd_barrier_complete(bar, b.x, nloc, nx); b.st[0] = nloc; b.st[1] = nx; }
        const unsigned old = xb_add(&bar[XB_XSUB(b.x)], 1u);
        const unsigned gen = old / nloc;
        if (old + 1u == (gen + 1u) * nloc) {
            __builtin_amdgcn_fence(__ATOMIC_RELEASE, "agent");
            asm volatile("s_waitcnt vmcnt(0)" ::: "memory");
            const unsigned og = xb_add(&bar[XB_TOP], 1u);
            const unsigned tg = og / nx;
            if (og + 1u == (tg + 1u) * nx) xb_add(&bar[XB_TOPGEN], 1u);
            else XB_SPIN(xb_ld(&bar[XB_TOPGEN]) == tg, bar);
            __builtin_amdgcn_fence(__ATOMIC_ACQUIRE, "agent");
            xb_add(&bar[XB_XGEN(b.x)], 1u);
            asm volatile("s_waitcnt vmcnt(0)" ::: "memory");
        } else {
            XB_SPIN(xb_ld(&bar[XB_XGEN(b.x)]) == gen, bar);
            __builtin_amdgcn_fence(__ATOMIC_ACQUIRE, "agent");
            asm volatile("s_waitcnt vmcnt(0)" ::: "memory");
        }
    }
    __syncthreads();
}

struct Args {
    const float* x; const float* w_in; const float* b_forget; const float* g_cq; const float* g_ckv; const float* w_uq; const float* w_uk; const float* w_uv;
    const float* w_branch; const float* w_out; const float* w_up; const float* w_down; const float* g_pre_mix; const float* g_post_mix; const float* g_pre_mlp; const float* g_post_mlp;
    float* out; unsigned char* ws;
};

template <int KIND  >
__device__ __forceinline__ void tr_item(const float* W, int ldw, int N, float cscale, const float* gk, bf16* WT, int ldt, int nrow_off, int kdst0, LAS float* scr, int item, int lane) {
    const int nblk = N / 32, kb = item / nblk, nb = item % nblk, k0 = 64 * kb, n0 = 32 * nb;
    const int j = n0 + (lane & 31);
    int c = j; float s = cscale;
    if (KIND == 1) {
        if (j < 768) { c = j; s = (j < 256) ? QS : 1.f; }
        else if (j < 1536) { c = 772 + (j - 768); s = (j < 1024) ? QS : 1.f; }
        else if (j < 2304) { c = 1540 + (j - 1536); s = (j < 1792) ? QS : 1.f; }
        else if (j < 2560) { c = 2308 + (j - 2304); s = 1.f; }
        else if (j < 2688) { c = 2564 + (j - 2560); s = 1.f; }
        else if (j < 2720) { c = 2692 + (j - 2688); s = 1.f; }
        else if (j < 2724) { c = 768 + (j - 2720); s = 1.f; }
        else { c = -1; s = 0.f; }
    }
    if (KIND == 2) { if (j >= 384) { c = -1; s = 0.f; } }
#pragma unroll 8
    for (int i = 0; i < 32; ++i) { const int kk = 2 * i + (lane >> 5);
        float v = 0.f;
        if (c >= 0) { v = W[(size_t)(k0 + kk) * ldw + c] * s; if (gk) v *= gk[k0 + kk]; }
        scr[kk * 33 + (lane & 31)] = v; }
    asm volatile("s_waitcnt lgkmcnt(0)" ::: "memory");
    const int c8 = lane & 7;
#pragma unroll
    for (int j4 = 0; j4 < 4; ++j4) { const int n = (lane >> 3) + 8 * j4; const LAS float* sp = scr + (8 * c8) * 33 + n;
        u32x4 o; o.x = pk2(sp[0 * 33], sp[1 * 33]); o.y = pk2(sp[2 * 33], sp[3 * 33]); o.z = pk2(sp[4 * 33], sp[5 * 33]); o.w = pk2(sp[6 * 33], sp[7 * 33]);
        *(GAS u32x4*)(WT + (size_t)(nrow_off + n0 + n) * ldt + kdst0 + k0 + 8 * c8) = o; }
    asm volatile("s_waitcnt lgkmcnt(0)" ::: "memory");
}

__device__ __forceinline__ void convert_weights(const Args& a, int l, int gw, int NGW, LAS float* scr, int lane) {
    unsigned char* wb = a.ws + WS_W;
    constexpr int I_IN = 16 * (PW / 32), I_G = 16 * 128, I_UQ = 4 * 16, I_UK = 2 * 8, I_UV = 2 * 8, I_B = 4 * 4 * 32, I_O = 16 * 32, I_UP = 16 * 128, I_DN = 64 * 32;
    constexpr int NITEMS = I_IN + I_G + I_UQ + I_UK + I_UV + I_B + I_O + I_UP + I_DN;
    for (int it = gw; it < NITEMS; it += NGW) {
        int r = it;
        if (r < I_IN) { tr_item<1>(a.w_in + (size_t)l * 1024 * DIN, DIN, PW, 1.f, nullptr, (bf16*)(wb + W_IN), 1024, 0, 0, scr, r, lane); continue; } r -= I_IN;
        if (r < I_G) { tr_item<0>(a.w_in + (size_t)l * 1024 * DIN + 2724, DIN, 4096, LOG2E, nullptr, (bf16*)(wb + W_G), 1024, 0, 0, scr, r, lane); continue; } r -= I_G;
        if (r < I_UQ) { tr_item<2>(a.w_uq + (size_t)l * 256 * 384, 384, 512, MS, a.g_cq + l * 256, (bf16*)(wb + W_UQ), 256, 0, 0, scr, r, lane); continue; } r -= I_UQ;
        if (r < I_UK) { tr_item<0>(a.w_uk + (size_t)l * 128 * 256, 256, 256, 1.f, a.g_ckv + l * 128, (bf16*)(wb + W_UKV), 256, 0, 0, scr, r, lane); continue; } r -= I_UK;
        if (r < I_UV) { tr_item<0>(a.w_uv + (size_t)l * 128 * 256, 256, 256, 1.f, a.g_ckv + l * 128, (bf16*)(wb + W_UKV), 256, 256, 0, scr, r, lane); continue; } r -= I_UV;
        if (r < I_B) { const int n = r / (4 * 32), rr = r % (4 * 32);
            tr_item<0>(a.w_branch + ((size_t)(l * 4 + n) * 256) * 1024, 1024, 1024, 1.f, nullptr, (bf16*)(wb + W_B), 1024, 0, n * 256, scr, rr, lane); continue; } r -= I_B;
        if (r < I_O) { tr_item<0>(a.w_out + (size_t)l * 1024 * 1024, 1024, 1024, 1.f, nullptr, (bf16*)(wb + W_O), 1024, 0, 0, scr, r, lane); continue; } r -= I_O;
        if (r < I_UP) { tr_item<0>(a.w_up + (size_t)l * 1024 * 4096, 4096, 4096, 1.f, nullptr, (bf16*)(wb + W_UP), 1024, 0, 0, scr, r, lane); continue; } r -= I_UP;
        tr_item<0>(a.w_down + (size_t)l * 4096 * 1024, 1024, 1024, 1.f, nullptr, (bf16*)(wb + W_DN), 4096, 0, 0, scr, r, lane);
    }
}

__device__ __forceinline__ void norm_row_to_bf16(const float* xrow, const float* g, bf16* orow, int lane) {
    const f32x4* xr = (const f32x4*)xrow + lane; const f32x4* gr = (const f32x4*)g + lane;
    f32x4 v[4]; float s = 0.f;
#pragma unroll
    for (int j = 0; j < 4; ++j) { v[j] = xr[64 * j]; s += (v[j].x * v[j].x + v[j].y * v[j].y) + (v[j].z * v[j].z + v[j].w * v[j].w); }
    const float rstd = 1.f / sqrtf(wave_sum(s) * (1.f / D) + NORM_EPS);
    unsigned long long* o8 = (unsigned long long*)orow + lane;
#pragma unroll
    for (int j = 0; j < 4; ++j) { const f32x4 gg = gr[64 * j];
        o8[64 * j] = (unsigned long long)pk2(v[j].x * rstd * gg.x, v[j].y * rstd * gg.y) | ((unsigned long long)pk2(v[j].z * rstd * gg.z, v[j].w * rstd * gg.w) << 32); }
}
__device__ __forceinline__ void resid_norm_row(const float* xrow, const bf16* yrow, const float* g1, float* xout, const float* g2, bf16* hrow, int lane) {
    const f32x4* xr = (const f32x4*)xrow + lane; const f32x4* g1r = (const f32x4*)g1 + lane;
    const unsigned long long* y8 = (const unsigned long long*)yrow + lane;
    f32x4 y[4]; float s = 0.f;
#pragma unroll
    for (int j = 0; j < 4; ++j) { const unsigned long long w = y8[64 * j]; const unsigned lo = (unsigned)w, hi = (unsigned)(w >> 32);
        y[j] = (f32x4){bflo(lo), bfhi(lo), bflo(hi), bfhi(hi)}; s += (y[j].x * y[j].x + y[j].y * y[j].y) + (y[j].z * y[j].z + y[j].w * y[j].w); }
    const float rstd = 1.f / sqrtf(wave_sum(s) * (1.f / D) + NORM_EPS);
    f32x4 v[4]; float s2 = 0.f;
#pragma unroll
    for (int j = 0; j < 4; ++j) { const f32x4 xx = xr[64 * j]; const f32x4 gg = g1r[64 * j];
        v[j] = xx + y[j] * rstd * gg; s2 += (v[j].x * v[j].x + v[j].y * v[j].y) + (v[j].z * v[j].z + v[j].w * v[j].w); }
    f32x4* xo = (f32x4*)xout + lane;
#pragma unroll
    for (int j = 0; j < 4; ++j) xo[64 * j] = v[j];
    if (hrow) {
        const float rstd2 = 1.f / sqrtf(wave_sum(s2) * (1.f / D) + NORM_EPS);
        const f32x4* g2r = (const f32x4*)g2 + lane; unsigned long long* o8 = (unsigned long long*)hrow + lane;
#pragma unroll
        for (int j = 0; j < 4; ++j) { const f32x4 gg = g2r[64 * j];
            o8[64 * j] = (unsigned long long)pk2(v[j].x * rstd2 * gg.x, v[j].y * rstd2 * gg.y) | ((unsigned long long)pk2(v[j].z * rstd2 * gg.z, v[j].w * rstd2 * gg.w) << 32); }
    }
}

namespace att {
constexpr int KB_BYTES = 12288, VB_BYTES = 8192, BUF_BYTES = KB_BYTES + VB_BYTES;
constexpr int SEL_OFF = 2 * BUF_BYTES;
constexpr float NEG = -1.0e30f;
enum { T_FOX = 0, T_MLA = 1, T_MOBA = 2, T_DIL = 3 };
typedef short v4i16_t __attribute__((ext_vector_type(4)));

__device__ __forceinline__ float xhalf_max(float m) { auto rr = __builtin_amdgcn_permlane32_swap(__float_as_uint(m), __float_as_uint(m), false, false); return fmaxf(__uint_as_float(rr[0]), __uint_as_float(rr[1])); }
__device__ __forceinline__ float xhalf_sum(float m) { auto rr = __builtin_amdgcn_permlane32_swap(__float_as_uint(m), __float_as_uint(m), false, false); return __uint_as_float(rr[0]) + __uint_as_float(rr[1]); }

struct State { f32x16 o0, o1; float m, l; };

template <int NKS>
__device__ __forceinline__ void tile_compute(State& st, const bf16x8* qf, const LAS unsigned char* kbuf, const LAS unsigned char* vbuf, bool domask, int qi, int kj0, unsigned W, bool rowok, int lane) {
    const int r32 = lane & 31, hi = lane >> 5;
    f32x16 p0, p1;
#pragma unroll
    for (int r = 0; r < 16; ++r) { p0[r] = 0.f; p1[r] = 0.f; }
#pragma unroll
    for (int ks = 0; ks < NKS; ++ks) {
        const bf16x8 k0 = *(const LAS bf16x8*)(kbuf + (2 * ks + hi) * 1024 + r32 * 16);
        const bf16x8 k1 = *(const LAS bf16x8*)(kbuf + (2 * ks + hi) * 1024 + (32 + r32) * 16);
        p0 = __builtin_amdgcn_mfma_f32_32x32x16_bf16(k0, qf[ks], p0, 0, 0, 0);
        p1 = __builtin_amdgcn_mfma_f32_32x32x16_bf16(k1, qf[ks], p1, 0, 0, 0);
    }
    if (domask) {
        const int base = qi - kj0 - 4 * hi;
#pragma unroll
        for (int r = 0; r < 16; ++r) { const int off = (r & 3) + 8 * (r >> 2);
            if ((unsigned)(base - off) > W) p0[r] = NEG;
            if ((unsigned)(base - off - 32) > W) p1[r] = NEG; }
    }
    if (!rowok) {
#pragma unroll
        for (int r = 0; r < 16; ++r) { p0[r] = NEG; p1[r] = NEG; }
    }
    float mx = fmaxf(p0[0], p1[0]);
#pragma unroll
    for (int r = 1; r < 16; ++r) mx = fmaxf(mx, fmaxf(p0[r], p1[r]));
    mx = xhalf_max(mx);
    const float mn = fmaxf(st.m, mx);
    const float alpha = __builtin_amdgcn_exp2f(st.m - mn);
    st.m = mn;
    float s = 0.f;
#pragma unroll
    for (int r = 0; r < 16; ++r) { p0[r] = __builtin_amdgcn_exp2f(p0[r] - mn); p1[r] = __builtin_amdgcn_exp2f(p1[r] - mn); s += p0[r] + p1[r]; }
    st.l = st.l * alpha + s;
#pragma unroll
    for (int r = 0; r < 16; ++r) { st.o0[r] *= alpha; st.o1[r] *= alpha; }
    bf16x8 pf[4];
#pragma unroll
    for (int q = 0; q < 2; ++q) {
        u32x4 a, b;
        a.x = cvt_pk_bf16(p0[8 * q + 0], p0[8 * q + 1]); a.y = cvt_pk_bf16(p0[8 * q + 2], p0[8 * q + 3]); a.z = cvt_pk_bf16(p0[8 * q + 4], p0[8 * q + 5]); a.w = cvt_pk_bf16(p0[8 * q + 6], p0[8 * q + 7]);
        b.x = cvt_pk_bf16(p1[8 * q + 0], p1[8 * q + 1]); b.y = cvt_pk_bf16(p1[8 * q + 2], p1[8 * q + 3]); b.z = cvt_pk_bf16(p1[8 * q + 4], p1[8 * q + 5]); b.w = cvt_pk_bf16(p1[8 * q + 6], p1[8 * q + 7]);
        pf[q] = __builtin_bit_cast(bf16x8, a); pf[2 + q] = __builtin_bit_cast(bf16x8, b);
    }
    const int li = lane & 15, g1 = (lane >> 4) & 1;
    const LAS unsigned char* vp = vbuf + (4 * hi + (li >> 2)) * 64 + 32 * g1 + 8 * (li & 3);
#pragma unroll
    for (int db = 0; db < 2; ++db)
#pragma unroll
        for (int sidx = 0; sidx < 4; ++sidx) {
            const s16x4 lo = __builtin_bit_cast(s16x4, __builtin_amdgcn_ds_read_tr16_b64_v4i16((LAS v4i16_t*)(vp + (db * 4 + sidx) * 1024)));
            const s16x4 hh = __builtin_bit_cast(s16x4, __builtin_amdgcn_ds_read_tr16_b64_v4i16((LAS v4i16_t*)(vp + (db * 4 + sidx) * 1024 + 512)));
            const bf16x8 vf = (bf16x8){lo[0], lo[1], lo[2], lo[3], hh[0], hh[1], hh[2], hh[3]};
            if (db == 0) st.o0 = __builtin_amdgcn_mfma_f32_32x32x16_bf16(vf, pf[sidx], st.o0, 0, 0, 0);
            else st.o1 = __builtin_amdgcn_mfma_f32_32x32x16_bf16(vf, pf[sidx], st.o1, 0, 0, 0);
        }
}

struct Stage { u32x4 k, v, x; };

template <int TYPE>
__device__ __forceinline__ void stage_load(Stage& sg, const bf16* Kp, int kpitch, const bf16* Vp, int vpitch, const bf16* Xp  ,
                                           long ktok0, int kstr, int kpos0  , int wid, int lane) {
    { const int kv = 8 * wid + (lane & 7), c = lane >> 3;
      sg.k = *(const u32x4*)(Kp + (size_t)(ktok0 + (long)kv * kstr) * kpitch + 8 * c); }
    { const int kv = 8 * wid + ((lane >> 4) & 3) * 2 + ((lane >> 2) & 1), c = (lane & 3) + 4 * ((lane >> 3) & 1);
      sg.v = *(const u32x4*)(Vp + (size_t)(ktok0 + (long)kv * kstr) * vpitch + 8 * c); }
    if (TYPE == T_MLA) {
        if (wid < 4) { const int kv = 16 * wid + (lane & 7) + 8 * (lane >> 5), cc = (lane >> 3) & 3;
            sg.x = *(const u32x4*)(Xp + (size_t)(ktok0 + kv) * PW + 8 * cc); }
    }
    if (TYPE == T_FOX) {
        if (wid == 0) { const float cm = -((const float*)Xp)[kpos0 + lane];
            const unsigned h = f2bf(cm); const float rem = cm - bf2f(h); const unsigned lo = f2bf(rem);
            sg.x = (u32x4){h | (lo << 16), 0u, 0u, 0u}; }
        else if (wid == 1) sg.x = (u32x4){0u, 0u, 0u, 0u};
    }
}
template <int TYPE>
__device__ __forceinline__ void stage_store(const Stage& sg, LAS unsigned char* buf, int wid, int lane) {
    { const int kv = 8 * wid + (lane & 7), c = lane >> 3;
      *(LAS u32x4*)(buf + c * 1024 + kv * 16) = sg.k; }
    { const int kv = 8 * wid + ((lane >> 4) & 3) * 2 + ((lane >> 2) & 1), c = (lane & 3) + 4 * ((lane >> 3) & 1);
      *(LAS u32x4*)(buf + KB_BYTES + (c >> 2) * 4096 + (kv >> 4) * 1024 + (kv & 15) * 64 + (c & 3) * 16) = sg.v; }
    if (TYPE == T_MLA) {
        if (wid < 4) { const int kv = 16 * wid + (lane & 7) + 8 * (lane >> 5), cc = (lane >> 3) & 3;
            *(LAS u32x4*)(buf + (8 + cc) * 1024 + kv * 16) = sg.x; }
    }
    if (TYPE == T_FOX) {
        if (wid < 2) *(LAS u32x4*)(buf + (8 + wid) * 1024 + lane * 16) = sg.x;
    }
}

__device__ __forceinline__ void finalize(const State& st, bf16* orow  , float* lse_ptr, int lane) {
    const int hi = lane >> 5;
    const float lt = xhalf_sum(st.l);
    const float inv = 1.f / lt;
#pragma unroll
    for (int g = 0; g < 4; ++g) {
        u32x2 a, b;
        a.x = cvt_pk_bf16(st.o0[4 * g + 0] * inv, st.o0[4 * g + 1] * inv); a.y = cvt_pk_bf16(st.o0[4 * g + 2] * inv, st.o0[4 * g + 3] * inv);
        b.x = cvt_pk_bf16(st.o1[4 * g + 0] * inv, st.o1[4 * g + 1] * inv); b.y = cvt_pk_bf16(st.o1[4 * g + 2] * inv, st.o1[4 * g + 3] * inv);
        *(u32x2*)(orow + 8 * g + 4 * hi) = a;
        *(u32x2*)(orow + 32 + 8 * g + 4 * hi) = b;
    }
    if (lse_ptr && hi == 0) *lse_ptr = st.m + __builtin_amdgcn_logf(lt);
}

template <int TYPE>
__device__ __forceinline__ void causal_unit(unsigned char* ws, int b, int h, int qb, LAS unsigned char* lds) {
    constexpr int NKS = (TYPE == T_FOX) ? 5 : (TYPE == T_MLA) ? 6 : 4;
    const int tid = my_tid(), lane = tid & 63, wid = __builtin_amdgcn_readfirstlane(tid >> 6), r32 = lane & 31, hi = lane >> 5;
    const bf16* proj = (const bf16*)(ws + WS_PROJ);
    const long tok0 = (long)b * SEQ;
    const bf16 *Qp, *Kp, *Vp, *Xp = nullptr; int qpitch, kpitch, vpitch, ocol;
    if (TYPE == T_FOX) { Qp = proj + C_FQ + 64 * h; Kp = proj + C_FK + 64 * h; Vp = proj + C_FV + 64 * h; qpitch = kpitch = vpitch = PW; ocol = 0 + 64 * h;
        Xp = (const bf16*)((const float*)(ws + WS_CUM) + (size_t)(b * NH + h) * SEQ); }
    else if (TYPE == T_MOBA) { Qp = proj + C_MQ + 64 * h; Kp = proj + C_MK + 64 * h; Vp = proj + C_MV + 64 * h; qpitch = kpitch = vpitch = PW; ocol = 512 + 64 * h; }
    else { Qp = (const bf16*)(ws + WS_QM) + 96 * h; qpitch = 384; Kp = (const bf16*)(ws + WS_KNVM) + 64 * h; Vp = (const bf16*)(ws + WS_KNVM) + 256 + 64 * h; kpitch = vpitch = 512;
        Xp = proj + C_KR; ocol = 768 + 64 * h; }
    const int qpos = 256 * qb + 32 * wid + r32;
    const long qtok = tok0 + qpos;
    bf16x8 qf[NKS];
#pragma unroll
    for (int ks = 0; ks < 4; ++ks) qf[ks] = *(const bf16x8*)(Qp + (size_t)qtok * qpitch + 16 * ks + 8 * hi);
    if constexpr (TYPE == T_FOX) { const u32x4 one = (u32x4){hi == 0 ? 0x3F803F80u : 0u, 0u, 0u, 0u}; qf[4] = __builtin_bit_cast(bf16x8, one); }
    if constexpr (TYPE == T_MLA) {
        const u32x4 x1 = *(const u32x4*)(Qp + (size_t)qtok * qpitch + 64 + 8 * hi), x2 = *(const u32x4*)(Qp + (size_t)qtok * qpitch + 80 + 8 * hi);
        const float* cm = (const float*)(ws + WS_ROPE) + 2 * 2048 * 8 + (size_t)qpos * 16 + 8 * hi; const float* sm = cm + 2048 * 16;
        unsigned o1[4], o2[4];
#pragma unroll
        for (int e = 0; e < 4; ++e) {
            const float a0 = bflo(x1[e]), a1 = bfhi(x1[e]), b0 = bflo(x2[e]), b1 = bfhi(x2[e]);
            const float c0 = cm[2 * e], c1 = cm[2 * e + 1], s0 = sm[2 * e], s1 = sm[2 * e + 1];
            o1[e] = cvt_pk_bf16(a0 * c0 - b0 * s0, a1 * c1 - b1 * s1);
            o2[e] = cvt_pk_bf16(b0 * c0 + a0 * s0, b1 * c1 + a1 * s1); }
        qf[4] = __builtin_bit_cast(bf16x8, ((u32x4){o1[0], o1[1], o1[2], o1[3]})); qf[5] = __builtin_bit_cast(bf16x8, ((u32x4){o2[0], o2[1], o2[2], o2[3]}));
    }
    unsigned sel = 0xffu;
    if (TYPE == T_MOBA) {
        LAS unsigned* selv = (LAS unsigned*)(lds + SEL_OFF);
        if (tid < 256) {
            unsigned sm_ = (1u << (qb + 1)) - 1u;
            if (qb >= 4) {
                const bf16* qrow = Qp + (size_t)(tok0 + 256 * qb + tid) * qpitch;
                float qv[64];
#pragma unroll
                for (int c = 0; c < 8; ++c) { const u32x4 w = *(const u32x4*)(qrow + 8 * c);
                    qv[8 * c + 0] = bflo(w.x); qv[8 * c + 1] = bfhi(w.x); qv[8 * c + 2] = bflo(w.y); qv[8 * c + 3] = bfhi(w.y);
                    qv[8 * c + 4] = bflo(w.z); qv[8 * c + 5] = bfhi(w.z); qv[8 * c + 6] = bflo(w.w); qv[8 * c + 7] = bfhi(w.w); }
                const float* ks = (const float*)(ws + WS_KSUM) + (size_t)(b * NH + h) * 8 * 2 * 64;
                float g0 = -3.0e38f, g1 = -3.0e38f, g2 = -3.0e38f; int i0 = 0, i1 = 0, i2 = 0;
                for (int n = 0; n < qb; ++n) {
                    const float* k0 = ks + n * 128; float gsum = 0.f;
#pragma unroll
                    for (int d = 0; d < 64; ++d) gsum += qv[d] * (k0[d] + k0[64 + d]);
                    if (gsum > g0) { g2 = g1; i2 = i1; g1 = g0; i1 = i0; g0 = gsum; i0 = n; }
                    else if (gsum > g1) { g2 = g1; i2 = i1; g1 = gsum; i1 = n; }
                    else if (gsum > g2) { g2 = gsum; i2 = n; }
                }
                sm_ = (1u << qb) | (1u << i0) | (1u << i1) | (1u << i2);
            }
            selv[tid] = sm_;
        }
        __syncthreads();
        sel = selv[32 * wid + r32];
    }
    State st;
#pragma unroll
    for (int r = 0; r < 16; ++r) { st.o0[r] = 0.f; st.o1[r] = 0.f; }
    st.m = NEG; st.l = 0.f;
    const int nt = 4 * qb + 4, diag = 4 * qb + (wid >> 1);
    Stage sg;
    stage_load<TYPE>(sg, Kp, kpitch, Vp, vpitch, Xp, tok0, 1, 0, wid, lane);
    stage_store<TYPE>(sg, lds, wid, lane);
    __syncthreads();
    for (int j = 0; j < nt; ++j) {
        LAS unsigned char* cur = lds + (j & 1) * BUF_BYTES; LAS unsigned char* nxb = lds + ((j + 1) & 1) * BUF_BYTES;
        if (j + 1 < nt) stage_load<TYPE>(sg, Kp, kpitch, Vp, vpitch, Xp, tok0 + 64 * (j + 1), 1, 64 * (j + 1), wid, lane);
        if (j <= diag) {
            const bool rowok = (TYPE == T_MOBA) ? (((sel >> (j >> 2)) & 1u) != 0u) : true;
            tile_compute<NKS>(st, qf, cur, cur + KB_BYTES, j == diag, qpos, 64 * j, 0x7fffffffu, rowok, lane);
        }
        if (j + 1 < nt) stage_store<TYPE>(sg, nxb, wid, lane);
        __syncthreads();
    }
    finalize(st, (bf16*)(ws + WS_YS) + (size_t)qtok * 1024 + ocol, nullptr, lane);
}

__device__ __forceinline__ void dil_unit(unsigned char* ws, int b, int h, int grp, int u, LAS unsigned char* lds) {
    const int tid = my_tid(), lane = tid & 63, wid = __builtin_amdgcn_readfirstlane(tid >> 6), r32 = lane & 31, hi = lane >> 5;
    const bf16* proj = (const bf16*)(ws + WS_PROJ);
    const long tok0 = (long)b * SEQ;
    const bf16* Qp = proj + C_DQ + 64 * h; const bf16* Kp = proj + C_DK + 64 * h; const bf16* Vp = proj + C_DV + 64 * h;
    const int dil = (grp == 0) ? 1 : (grp == 1) ? 4 : 16;
    int qres, q0;
    if (grp == 0) { qres = 0; q0 = 256 * u + 32 * wid; }
    else if (grp == 1) { qres = u >> 1; q0 = 256 * (u & 1) + 32 * wid; }
    else { qres = 2 * u + (wid >> 2); q0 = 32 * (wid & 3); }
    const int qs = q0 + r32;
    const long qtok = tok0 + (long)qs * dil + qres;
    bf16x8 qf[4];
#pragma unroll
    for (int ks = 0; ks < 4; ++ks) qf[ks] = *(const bf16x8*)(Qp + (size_t)qtok * PW + 16 * ks + 8 * hi);
    State st;
#pragma unroll
    for (int r = 0; r < 16; ++r) { st.o0[r] = 0.f; st.o1[r] = 0.f; }
    st.m = NEG; st.l = 0.f;
    const int Q0 = (grp == 0) ? 256 * u : (grp == 1) ? 256 * (u & 1) : 0;
    const int jlo = (grp == 2) ? 0 : (Q0 == 0 ? 2 : 0), jhi = (grp == 2) ? 4 : 6;
#define DIL_TILE(jj, KS0, KRES) do { if (grp == 2) { KS0 = 64 * ((jj) & 1); KRES = 2 * u + ((jj) >> 1); } else { KS0 = Q0 - 128 + 64 * (jj); KRES = (grp == 1) ? (u >> 1) : 0; } } while (0)
    Stage sg;
    { int ks0, kres; DIL_TILE(jlo, ks0, kres);
      stage_load<T_DIL>(sg, Kp, PW, Vp, PW, nullptr, tok0 + (long)ks0 * dil + kres, dil, 0, wid, lane);
      stage_store<T_DIL>(sg, lds, wid, lane); }
    __syncthreads();
    for (int j = jlo; j < jhi; ++j) {
        const int it = j - jlo;
        LAS unsigned char* cur = lds + (it & 1) * BUF_BYTES; LAS unsigned char* nxb = lds + ((it + 1) & 1) * BUF_BYTES;
        if (j + 1 < jhi) { int ks0, kres; DIL_TILE(j + 1, ks0, kres);
            stage_load<T_DIL>(sg, Kp, PW, Vp, PW, nullptr, tok0 + (long)ks0 * dil + kres, dil, 0, wid, lane); }
        int ks0, kres; DIL_TILE(j, ks0, kres);
        bool active;
        if (grp == 2) active = ((j >> 1) == (wid >> 2)) && ((j & 1) <= ((wid & 3) >> 1));
        else active = (j >= (wid >> 1)) && (j <= (wid >> 1) + 2);
        if (active) tile_compute<4>(st, qf, cur, cur + KB_BYTES, true, qs, ks0, 128u, true, lane);
        if (j + 1 < jhi) stage_store<T_DIL>(sg, nxb, wid, lane);
        __syncthreads();
    }
#undef DIL_TILE
    bf16* obase = (grp == 0) ? (bf16*)(ws + WS_YS) + (size_t)qtok * 1024 + 256 + 64 * h
                             : (bf16*)(ws + WS_OD) + (size_t)(grp - 1) * M * 256 + (size_t)qtok * 256 + 64 * h;
    float* lse = (float*)(ws + WS_LSE) + ((size_t)grp * M + qtok) * 4 + h;
    finalize(st, obase, lse, lane);
}
}

struct SchedUniform {
    const char* A; const char* B; unsigned pa, pb; int nM, nN, nt, G, c;
    __device__ __forceinline__ bool next(int i, pg8::Unit& u) const {
        const long L = (long)i * G + c; if (L >= (long)nM * nN) return false;
        int pm, pn; pg8::tile_of((int)L, nM, nN, pm, pn);
        u.pm = pm; u.pn = pn; u.nt = nt; u.tag = 0; u.A = A + (size_t)pm * 256 * pa; u.B = B + (size_t)pn * 256 * pb; return true;
    }
};
struct SchedMla {
    const char* Aq; const char* Akv; const char* Bq; const char* Bkv; int G, c;
    __device__ __forceinline__ bool next(int i, pg8::Unit& u) const {
        const long L = (long)(i >> 1) * G + c; if (L >= 256) return false;
        int pm, pn; pg8::tile_of((int)L, 128, 2, pm, pn);
        u.pm = pm; u.pn = pn; u.tag = i & 1;
        if ((i & 1) == 0) { u.nt = 4; u.A = Aq + (size_t)pm * 256 * (PW * 2); u.B = Bq + (size_t)pn * 256 * 512; }
        else { u.nt = 2; u.A = Akv + (size_t)pm * 256 * (PW * 2); u.B = Bkv + (size_t)pn * 256 * 512; }
        return true;
    }
};
struct EpiMla {
    pg8::EpiStore<2> eq, ekv;
    __device__ __forceinline__ void operator()(const f32x4 (&acc)[2][2][4][2], const pg8::Unit& u, int wr, int wc, int fr, int fq) const {
        if (u.tag == 0) eq(acc, u, wr, wc, fr, fq); else ekv(acc, u, wr, wc, fr, fq);
    }
};
struct SchedGate {
    const char* YS; const char* H; const char* WB; const char* WG; int G, c;
    __device__ __forceinline__ bool next(int i, pg8::Unit& u) const {
        const long L = (long)(i >> 3) * G + c; if (L >= 512) return false;
        int pm, pn; pg8::tile_of((int)L, 128, 4, pm, pn);
        const int sub = i & 7, n = sub >> 1, kind = sub & 1;
        u.pm = pm; u.pn = pn; u.tag = sub;
        if (kind == 0) { u.nt = 4; u.A = YS + (size_t)pm * 256 * 2048 + n * 512; u.B = WB + (size_t)pn * 256 * 2048 + n * 512; }
        else { u.nt = 16; u.A = H + (size_t)pm * 256 * 2048; u.B = WG + (size_t)(n * 1024 + pn * 256) * 2048; }
        return true;
    }
};

#define NOINL __forceinline__
template <class T> __device__ __forceinline__ T* uni(T* p) { unsigned long long v = (unsigned long long)p; asm volatile("" : "+s"(v)); return (T*)v; }
__device__ __forceinline__ int uni(int v) { asm volatile("" : "+s"(v)); return v; }
__device__ __forceinline__ LAS unsigned char* lds_base() { extern __shared__ __attribute__((aligned(16))) unsigned char lds_raw[]; return (LAS unsigned char*)lds_raw; }
__device__ __forceinline__ int vcu_of() { const int G = my_grid(), bx = my_bid(); return (G % 8 == 0) ? (bx % 8) * (G / 8) + bx / 8 : bx; }

__device__ NOINL void ph_convert(const float* w_in, const float* g_cq, const float* g_ckv, const float* w_uq, const float* w_uk, const float* w_uv,
                                 const float* w_branch, const float* w_out, const float* w_up, const float* w_down, unsigned char* ws, int l) {
    Args a{}; a.w_in = uni(w_in); a.g_cq = uni(g_cq); a.g_ckv = uni(g_ckv); a.w_uq = uni(w_uq); a.w_uk = uni(w_uk); a.w_uv = uni(w_uv);
    a.w_branch = uni(w_branch); a.w_out = uni(w_out); a.w_up = uni(w_up); a.w_down = uni(w_down); a.ws = uni(ws); l = uni(l);
    const int tid = my_tid(), lane = tid & 63, wave = __builtin_amdgcn_readfirstlane(tid >> 6);
    convert_weights(a, l, vcu_of() * 8 + wave, my_grid() * 8, (LAS float*)(lds_base() + wave * 16384), lane);
}
__device__ NOINL void ph_tables(unsigned char* ws) {
    ws = uni(ws);
    const int tid = my_tid(), bx = my_bid(), G = my_grid();
    float* rt = (float*)(ws + WS_ROPE);
    for (int i = bx * 512 + tid; i < 2048 * 8; i += G * 512) { const int pos = i >> 3, k = i & 7;
        const float inv = 1.0f / powf(500000.0f, (float)(2 * k) / 16.0f); const float ang = (float)pos * inv;
        rt[i] = cosf(ang); rt[2048 * 8 + i] = sinf(ang); }
    for (int i = bx * 512 + tid; i < 2048 * 16; i += G * 512) { const int pos = i >> 4, k = i & 15;
        const float inv = 1.0f / powf(500000.0f, (float)(2 * k) / 32.0f); const float ang = (float)pos * inv;
        rt[2 * 2048 * 8 + i] = cosf(ang); rt[2 * 2048 * 8 + 2048 * 16 + i] = sinf(ang); }
}
__device__ NOINL void ph_norm0(const float* x, const float* g, unsigned char* ws) {
    x = uni(x); g = uni(g); ws = uni(ws);
    const int tid = my_tid(), lane = tid & 63, wave = __builtin_amdgcn_readfirstlane(tid >> 6);
    const int gw = vcu_of() * 8 + wave, NGW = my_grid() * 8;
    bf16* Hb = (bf16*)(ws + WS_H);
    for (int m = gw; m < M; m += NGW) norm_row_to_bf16(x + (size_t)m * D, g, Hb + (size_t)m * D, lane);
}
__device__ NOINL void ph_inproj(unsigned char* ws) {
    ws = uni(ws);
    SchedUniform S{(const char*)(ws + WS_H), (const char*)(ws + WS_W + W_IN), 2048u, 2048u, 128, PW / 256, 16, my_grid(), my_bid()};
    pg8::EpiStore<0> E{(bf16*)(ws + WS_PROJ), PW, nullptr, PW, 0};
    pg8::gemm_phase(lds_base(), 2048u, 2048u, S, E);
}
__device__ NOINL void ph_prep(unsigned char* ws, const float* b_forget_l) {
    ws = uni(ws); b_forget_l = uni(b_forget_l);
    LAS unsigned char* lds = lds_base();
    const int tid = my_tid(), lane = tid & 63, wave = __builtin_amdgcn_readfirstlane(tid >> 6), vcu = vcu_of();
    bf16* proj = (bf16*)(ws + WS_PROJ);
    const int b = vcu >> 4, blk = (vcu >> 1) & 7, half = vcu & 1;
    const float* cp = (const float*)(ws + WS_ROPE); const float* sp = cp + 2048 * 8; const float* cm = cp + 2 * 2048 * 8; const float* sm = cm + 2048 * 16;
    const int j = lane & 15;
    float ksum[4] = {0.f, 0.f, 0.f, 0.f};
    for (int i = 0; i < 16; ++i) {
        const int pos = blk * 256 + half * 128 + wave * 16 + i; const size_t tok = (size_t)b * SEQ + pos;
        bf16* row = proj + tok * PW;
        f32x4 cs = (f32x4){1.f, 1.f, 1.f, 1.f}, sn = (f32x4){0.f, 0.f, 0.f, 0.f};
        if (j < 4) { cs = *(const f32x4*)(cp + pos * 8 + 4 * (j & 1)); sn = *(const f32x4*)(sp + pos * 8 + 4 * (j & 1)); }
#pragma unroll
        for (int t = 0; t < 4; ++t) {
            const int col = (t == 0 ? C_DQ : t == 1 ? C_DK : t == 2 ? C_MQ : C_MK) + 4 * lane;
            const u32x2 w = *(const u32x2*)(row + col);
            float v[4] = {bflo(w.x), bfhi(w.x), bflo(w.y), bfhi(w.y)}; float o[4];
#pragma unroll
            for (int e = 0; e < 4; ++e) { const float pv = __shfl_xor(v[e], 2);
                o[e] = (j < 2) ? (v[e] * cs[e] - pv * sn[e]) : (j < 4) ? (v[e] * cs[e] + pv * sn[e]) : v[e]; }
            if (j < 4) { u32x2 ow; ow.x = cvt_pk_bf16(o[0], o[1]); ow.y = cvt_pk_bf16(o[2], o[3]); *(u32x2*)(row + col) = ow;
                o[0] = bflo(ow.x); o[1] = bfhi(ow.x); o[2] = bflo(ow.y); o[3] = bfhi(ow.y); }
            if (t == 3) { ksum[0] += o[0]; ksum[1] += o[1]; ksum[2] += o[2]; ksum[3] += o[3]; }
        }
        if (lane < 16) { const float x1 = bf2f(row[C_KR + lane]), x2 = bf2f(row[C_KR + 16 + lane]); const float c = cm[pos * 16 + lane], s = sm[pos * 16 + lane];
            row[C_KR + lane] = (bf16)f2bf(x1 * c - x2 * s); row[C_KR + 16 + lane] = (bf16)f2bf(x2 * c + x1 * s); }
        { const u32x2 w = *(const u32x2*)(row + C_CQ + 4 * lane); const float v0 = bflo(w.x), v1 = bfhi(w.x), v2 = bflo(w.y), v3 = bfhi(w.y);
          const float ss = wave_sum((v0 * v0 + v1 * v1) + (v2 * v2 + v3 * v3));
          const unsigned w2 = *(const unsigned*)(row + C_CKV + 2 * lane); const float u0 = bflo(w2), u1 = bfhi(w2);
          const float s2 = wave_sum(u0 * u0 + u1 * u1);
          if (lane == 0) { ((float*)(ws + WS_RSQ))[tok] = 1.f / sqrtf(ss * (1.f / 256.f) + NORM_EPS); ((float*)(ws + WS_RSKV))[tok] = 1.f / sqrtf(s2 * (1.f / 128.f) + NORM_EPS); } }
    }
    LAS float* red = (LAS float*)lds;
#pragma unroll
    for (int e = 0; e < 4; ++e) red[wave * 256 + 4 * lane + e] = ksum[e];
    __syncthreads();
    if (tid < 256) { float s = 0.f;
#pragma unroll
        for (int w = 0; w < 8; ++w) s += red[w * 256 + tid];
        const int h2 = tid >> 6, d = tid & 63;
        ((float*)(ws + WS_KSUM))[((((size_t)b * NH + h2) * 8 + blk) * 2 + half) * 64 + d] = s * (1.f / 256.f); }
    __syncthreads();
    if (vcu < 64 && wave == 0) {
        const int b2 = vcu >> 2, h2 = vcu & 3; const float bias = b_forget_l[h2];
        float c[32]; float run = 0.f;
#pragma unroll
        for (int i = 0; i < 32; ++i) { const size_t tok = (size_t)b2 * SEQ + 32 * lane + i;
            const float z = bf2f(proj[tok * PW + C_FF + h2]) + bias;
            const float ls = (z >= 0.f) ? -log1pf(expf(-z)) : (z - log1pf(expf(z)));
            run += ls * LOG2E; c[i] = run; }
        float tot = run;
#pragma unroll
        for (int o = 1; o < 64; o <<= 1) { const float t = __shfl_up(tot, o); if (lane >= o) tot += t; }
        const float off = tot - run;
        float* dst = (float*)(ws + WS_CUM) + (size_t)(b2 * NH + h2) * SEQ + 32 * lane;
#pragma unroll
        for (int i = 0; i < 32; i += 4) *(f32x4*)(dst + i) = (f32x4){c[i] + off, c[i + 1] + off, c[i + 2] + off, c[i + 3] + off};
    }
}
__device__ NOINL void ph_mlaup(unsigned char* ws) {
    ws = uni(ws);
    const bf16* proj = (const bf16*)(ws + WS_PROJ);
    SchedMla S{(const char*)(proj + C_CQ), (const char*)(proj + C_CKV), (const char*)(ws + WS_W + W_UQ), (const char*)(ws + WS_W + W_UKV), my_grid(), my_bid()};
    EpiMla E{ pg8::EpiStore<2>{(bf16*)(ws + WS_QM), 384, (const float*)(ws + WS_RSQ), 384, 0}, pg8::EpiStore<2>{(bf16*)(ws + WS_KNVM), 512, (const float*)(ws + WS_RSKV), 512, 0} };
    pg8::gemm_phase(lds_base(), (unsigned)(PW * 2), 512u, S, E);
}
template <int TYPE> __device__ NOINL void ph_attn_causal(unsigned char* ws) {
    ws = uni(ws);
    const int vcu = vcu_of(), bh = vcu >> 2, pr = vcu & 3, b = bh >> 2, h = bh & 3;
    att::causal_unit<TYPE>(ws, b, h, 7 - pr, lds_base());
    att::causal_unit<TYPE>(ws, b, h, pr, lds_base());
}
__device__ NOINL void ph_attn_dil(unsigned char* ws) {
    ws = uni(ws);
    const int vcu = vcu_of(), bh = vcu >> 2, pr = vcu & 3, b = bh >> 2, h = bh & 3;
    for (int k = 0; k < 6; ++k) {
        const int grp = k >> 1; int u;
        if (grp == 0) u = (k & 1) ? 7 - pr : pr; else if (grp == 1) u = 2 * pr + (k & 1); else u = pr + 4 * (k & 1);
        att::dil_unit(ws, b, h, grp, u, lds_base());
    }
}
__device__ NOINL void ph_dilmerge(unsigned char* ws) {
    ws = uni(ws);
    const int tid = my_tid(), bx = my_bid(), G = my_grid();
    bf16* ys = (bf16*)(ws + WS_YS); const bf16* od = (const bf16*)(ws + WS_OD); const float* lse = (const float*)(ws + WS_LSE);
    for (int i = bx * 512 + tid; i < M * 32; i += G * 512) {
        const int tok = i >> 5, ch = i & 31, h = ch >> 3;
        const float l0 = lse[(size_t)tok * 4 + h], l1 = lse[((size_t)M + tok) * 4 + h], l2 = lse[((size_t)2 * M + tok) * 4 + h];
        const float mx = fmaxf(l0, fmaxf(l1, l2));
        float w0 = __builtin_amdgcn_exp2f(l0 - mx), w1 = __builtin_amdgcn_exp2f(l1 - mx), w2 = __builtin_amdgcn_exp2f(l2 - mx);
        const float inv = 1.f / (w0 + w1 + w2); w0 *= inv; w1 *= inv; w2 *= inv;
        bf16* yp = ys + (size_t)tok * 1024 + 256 + 8 * ch;
        const u32x4 v0 = *(const u32x4*)yp, v1 = *(const u32x4*)(od + (size_t)tok * 256 + 8 * ch), v2 = *(const u32x4*)(od + ((size_t)M + tok) * 256 + 8 * ch);
        u32x4 o;
#pragma unroll
        for (int e = 0; e < 4; ++e) o[e] = cvt_pk_bf16(w0 * bflo(v0[e]) + w1 * bflo(v1[e]) + w2 * bflo(v2[e]), w0 * bfhi(v0[e]) + w1 * bfhi(v1[e]) + w2 * bfhi(v2[e]));
        *(u32x4*)yp = o;
    }
}
__device__ NOINL void ph_gate(unsigned char* ws) {
    ws = uni(ws);
    SchedGate S{(const char*)(ws + WS_YS), (const char*)(ws + WS_H), (const char*)(ws + WS_W + W_B), (const char*)(ws + WS_W + W_G), my_grid(), my_bid()};
    pg8::EpiGate E{(bf16*)(ws + WS_USCR) + (size_t)my_bid() * 65536, (bf16*)(ws + WS_MERGED)};
    pg8::gemm_phase(lds_base(), 2048u, 2048u, S, E);
}
__device__ NOINL void ph_wout(unsigned char* ws) {
    ws = uni(ws);
    SchedUniform S{(const char*)(ws + WS_MERGED), (const char*)(ws + WS_W + W_O), 2048u, 2048u, 128, 4, 16, my_grid(), my_bid()};
    pg8::EpiStore<0> E{(bf16*)(ws + WS_H), 1024, nullptr, 1024, 0};
    pg8::gemm_phase(lds_base(), 2048u, 2048u, S, E);
}
__device__ NOINL void ph_resid(const float* xin, float* xout, unsigned char* ws, const float* g1, const float* g2) {
    xin = uni(xin); xout = uni(xout); ws = uni(ws); g1 = uni(g1); g2 = uni(g2);
    const int tid = my_tid(), lane = tid & 63, wave = __builtin_amdgcn_readfirstlane(tid >> 6);
    const int gw = vcu_of() * 8 + wave, NGW = my_grid() * 8;
    bf16* Hb = (bf16*)(ws + WS_H);
    for (int m = gw; m < M; m += NGW)
        resid_norm_row(xin + (size_t)m * D, Hb + (size_t)m * D, g1, xout + (size_t)m * D, g2, g2 ? Hb + (size_t)m * D : nullptr, lane);
}
__device__ NOINL void ph_up(unsigned char* ws, int hf) {
    ws = uni(ws); hf = uni(hf);
    SchedUniform S{(const char*)(ws + WS_H) + (size_t)hf * (M / 2) * D * 2, (const char*)(ws + WS_W + W_UP), 2048u, 2048u, 64, 16, 16, my_grid(), my_bid()};
    pg8::EpiStore<1> E{(bf16*)(ws + WS_HID), DFF, nullptr, DFF, 0};
    pg8::gemm_phase(lds_base(), 2048u, 2048u, S, E);
}
__device__ NOINL void ph_down(unsigned char* ws, int hf) {
    ws = uni(ws); hf = uni(hf);
    SchedUniform S{(const char*)(ws + WS_HID), (const char*)(ws + WS_W + W_DN), 8192u, 8192u, 64, 4, 64, my_grid(), my_bid()};
    pg8::EpiStore<0> E{(bf16*)(ws + WS_H), 1024, nullptr, 1024, hf * (M / 2)};
    pg8::gemm_phase(lds_base(), 8192u, 8192u, S, E);
}

__global__ void __launch_bounds__(512, 2) fwd_kernel(Args a) {
    LAS unsigned char* lds = lds_base();
    volatile LAS unsigned* MISC = (volatile LAS unsigned*)(lds + MISC_OFF);
    const int tid = my_tid();
    unsigned char* ws = a.ws;
    if (tid < 64) MISC[tid] = 0u;
    __syncthreads();
    XcdBarrier bar = xcd_barrier_post((unsigned*)(ws + WS_CTL) + CW_BAR, MISC + 8);

#if (PHM >> 0) & 1
    ph_convert(a.w_in, a.g_cq, a.g_ckv, a.w_uq, a.w_uk, a.w_uv, a.w_branch, a.w_out, a.w_up, a.w_down, ws, 0);
    ph_tables(ws);
    ph_norm0(a.x, a.g_pre_mix, ws);
#endif
    xcd_barrier(bar);

    for (int l = 0; l < DEPTH; ++l) {
#if (PHM >> 1) & 1
        ph_inproj(ws);
#endif
        xcd_barrier(bar);
#if (PHM >> 2) & 1
        ph_prep(ws, a.b_forget + l * NH);
#endif
        xcd_barrier(bar);
#if (PHM >> 3) & 1
        ph_mlaup(ws);
#endif
        xcd_barrier(bar);
#if (PHM >> 4) & 1
        ph_attn_causal<att::T_FOX>(ws);
#endif
#if (PHM >> 11) & 1
        ph_attn_causal<att::T_MLA>(ws);
#endif
#if (PHM >> 12) & 1
        ph_attn_causal<att::T_MOBA>(ws);
#endif
#if (PHM >> 13) & 1
        ph_attn_dil(ws);
#endif
        xcd_barrier(bar);
#if (PHM >> 5) & 1
        ph_dilmerge(ws);
#endif
        xcd_barrier(bar);
#if (PHM >> 6) & 1
        ph_gate(ws);
#endif
        xcd_barrier(bar);
#if (PHM >> 7) & 1
        ph_wout(ws);
#endif
        xcd_barrier(bar);
#if (PHM >> 8) & 1
        ph_resid(l == 0 ? a.x : a.out, a.out, ws, a.g_post_mix + l * D, a.g_pre_mlp + l * D);
#endif
        xcd_barrier(bar);
        for (int hf = 0; hf < 2; ++hf) {
#if (PHM >> 9) & 1
            ph_up(ws, hf);
#endif
            xcd_barrier(bar);
#if (PHM >> 14) & 1
            ph_down(ws, hf);
#endif
            xcd_barrier(bar);
        }
        const bool lastl = (l == DEPTH - 1);
#if (PHM >> 10) & 1
        ph_resid(a.out, a.out, ws, a.g_post_mlp + l * D, lastl ? nullptr : a.g_pre_mix + (l + 1) * D);
#endif
        if (!lastl) {
            __syncthreads();
#if (PHM >> 10) & 1
            ph_convert(a.w_in, a.g_cq, a.g_ckv, a.w_uq, a.w_uk, a.w_uv, a.w_branch, a.w_out, a.w_up, a.w_down, ws, l + 1);
#endif
            xcd_barrier(bar);
        }
    }
}

extern "C" void kernel_launch(void* const* d_in, const int* in_sizes, int n_in, void* d_out, int out_size, void* d_ws, size_t ws_size, hipStream_t stream) {
    static int grid = 0;
    if (grid == 0) {
        if (n_in != 16 || in_sizes[0] != M * D || out_size != M * D || ws_size < WS_END) {
            fprintf(stderr, "kernel_launch: unexpected shapes: n_in %d in0 %d out %d ws %zu (need %zu)\n", n_in, n_in > 0 ? in_sizes[0] : -1, out_size, ws_size, (size_t)WS_END); grid = -1; return; }
        int dev = 0, cus = 0, per_cu = 0;
        if (hipGetDevice(&dev) != hipSuccess || hipDeviceGetAttribute(&cus, hipDeviceAttributeMultiprocessorCount, dev) != hipSuccess) { grid = -1; return; }
        if (hipFuncSetAttribute((const void*)fwd_kernel, hipFuncAttributeMaxDynamicSharedMemorySize, LDS_BYTES) != hipSuccess) { fprintf(stderr, "kernel_launch: hipFuncSetAttribute failed\n"); grid = -1; return; }
        if (hipOccupancyMaxActiveBlocksPerMultiprocessor(&per_cu, (const void*)fwd_kernel, 512, LDS_BYTES) != hipSuccess || per_cu < 1)
            fprintf(stderr, "kernel_launch: occupancy query reports %d workgroups per CU\n", per_cu);
        (void)hipGetLastError();
        grid = cus;
        if (grid != 256) fprintf(stderr, "kernel_launch: %d CUs (built for 256)\n", grid);
    }
    if (grid < 0) return;
    if (hipMemsetAsync((char*)d_ws + WS_CTL, 0, CTL_ZERO_BYTES, stream) != hipSuccess) return;
    Args a{};
    a.x = (const float*)d_in[0]; a.w_in = (const float*)d_in[1]; a.b_forget = (const float*)d_in[2]; a.g_cq = (const float*)d_in[3]; a.g_ckv = (const float*)d_in[4];
    a.w_uq = (const float*)d_in[5]; a.w_uk = (const float*)d_in[6]; a.w_uv = (const float*)d_in[7]; a.w_branch = (const float*)d_in[8]; a.w_out = (const float*)d_in[9];
    a.w_up = (const float*)d_in[10]; a.w_down = (const float*)d_in[11]; a.g_pre_mix = (const float*)d_in[12]; a.g_post_mix = (const float*)d_in[13];
    a.g_pre_mlp = (const float*)d_in[14]; a.g_post_mlp = (const float*)d_in[15];
    a.out = (float*)d_out; a.ws = (unsigned char*)d_ws;
    hipLaunchKernelGGL(fwd_kernel, dim3(grid), dim3(512), LDS_BYTES, stream, a);
}
```
